# Optimizing an MI355X kernel written in HIP

```python
import jax, jax.numpy as jnp
from jax import lax
import numpy as np

D_MODEL = 1024
BATCH = 8
SEQ = 2048
DEPTH = 1

CHUNK = 64
D_MIX = D_MODEL
D_HGRN = D_MIX // 2
D_CONV = D_MIX - D_HGRN
HGRN_HEAD_DIM = 128
HGRN_HEADS = D_HGRN // HGRN_HEAD_DIM
CONV_WIDTH = 3
CONV_GROUPS = 8
EPS = 1e-6
IN_COLS = 4 * D_HGRN + 4 * D_CONV

kernel_name = "hgrn2_shortconv_parallel_hybrid"


def rmsnorm(x, g):
    xf = x.astype(jnp.float32)
    y = xf * lax.rsqrt(jnp.mean(xf * xf, axis=-1, keepdims=True) + EPS)
    return (y * g.astype(jnp.float32)).astype(x.dtype)


def grouped_rmsnorm(x, g, n_groups):
    bsz, s, w = x.shape
    xf = x.astype(jnp.float32).reshape(bsz, s, n_groups, w // n_groups)
    y = xf * lax.rsqrt(jnp.mean(xf * xf, axis=-1, keepdims=True) + EPS)
    return (y.reshape(bsz, s, w) * g.astype(jnp.float32)).astype(x.dtype)


def hgrn2_chunkwise(q, log_f, k, v):
    bsz, s, h, dk = q.shape
    dv = v.shape[-1]
    nc = s // CHUNK

    def split(t):
        return t.reshape(bsz, nc, CHUNK, h, t.shape[-1]).transpose(0, 3, 1, 2, 4)

    q, log_f, k, v = (split(t).astype(jnp.float32) for t in (q, log_f, k, v))
    b = jnp.cumsum(log_f, axis=3)
    g = b[..., -1:, :]
    q_dec = q * jnp.exp(b)
    k_inv = k * jnp.exp(-b)
    k_end = k * jnp.exp(g - b)
    causal = jnp.tril(jnp.ones((CHUNK, CHUNK), dtype=bool))
    scores = jnp.einsum('bhnck,bhnsk->bhncs', q_dec, k_inv)
    scores = jnp.where(causal, scores, 0.0)
    o_intra = jnp.einsum('bhncs,bhnsv->bhncv', scores, v)
    chunk_update = jnp.einsum('bhnsk,bhnsv->bhnkv', k_end, v)
    chunk_decay = jnp.exp(g[..., 0, :])

    def step(state, inp):
        dec, upd = inp
        return dec[..., None] * state + upd, state

    s0 = jnp.zeros((bsz, h, dk, dv), jnp.float32)
    _, s_before = lax.scan(step, s0, (jnp.moveaxis(chunk_decay, 2, 0),
                                      jnp.moveaxis(chunk_update, 2, 0)))
    s_before = jnp.moveaxis(s_before, 0, 2)
    o_inter = jnp.einsum('bhnck,bhnkv->bhncv', q_dec, s_before)
    o = o_intra + o_inter
    return o.transpose(0, 2, 3, 1, 4).reshape(bsz, s, h, dv)


def causal_depthwise_conv(u, w):
    c = u.shape[-1]
    return lax.conv_general_dilated(
        u, w.astype(u.dtype)[:, None, :], window_strides=(1,),
        padding=[(CONV_WIDTH - 1, 0)],
        dimension_numbers=('NWC', 'WIO', 'NWC'), feature_group_count=c)


def setup_inputs(seed: int = 0) -> dict:
    key = jax.random.key(seed)
    ks = jax.random.split(key, 9)
    f32 = jnp.float32
    x = jax.random.normal(ks[0], (BATCH, SEQ, D_MODEL), f32)
    norm_gain = 1.0 + 0.02 * jax.random.normal(ks[1], (DEPTH, D_MODEL), f32)
    w_in = jax.random.normal(ks[2], (DEPTH, D_MODEL, IN_COLS), f32) * D_MODEL ** -0.5
    lb_logits = 1.0 + 0.1 * jax.random.normal(ks[3], (DEPTH + 1, D_HGRN), f32)
    conv_w = jax.random.normal(ks[4], (DEPTH, CONV_WIDTH, D_CONV), f32) * CONV_WIDTH ** -0.5
    hgrn_norm_gain = 1.0 + 0.02 * jax.random.normal(ks[5], (DEPTH, D_HGRN), f32)
    conv_norm_gain = 1.0 + 0.02 * jax.random.normal(ks[6], (DEPTH, D_CONV), f32)
    w_out = jax.random.normal(ks[7], (DEPTH, D_MIX, D_MODEL), f32) * D_MIX ** -0.5
    final_norm_gain = 1.0 + 0.02 * jax.random.normal(ks[8], (D_MODEL,), f32)
    return {"x": x, "norm_gain": norm_gain, "w_in": w_in, "lb_logits": lb_logits,
            "conv_w": conv_w, "hgrn_norm_gain": hgrn_norm_gain,
            "conv_norm_gain": conv_norm_gain, "w_out": w_out,
            "final_norm_gain": final_norm_gain}


def reference(x, norm_gain, w_in, lb_logits, conv_w, hgrn_norm_gain,
              conv_norm_gain, w_out, final_norm_gain):
    bsz, s, _ = x.shape
    lower_bounds = jnp.cumsum(jax.nn.softmax(lb_logits.astype(jnp.float32), axis=0), axis=0)
    splits = [D_HGRN, 2 * D_HGRN, 3 * D_HGRN, 4 * D_HGRN,
              4 * D_HGRN + D_CONV, 4 * D_HGRN + 2 * D_CONV, 4 * D_HGRN + 3 * D_CONV]
    for l in range(DEPTH):
        h = rmsnorm(x, norm_gain[l])
        proj = jnp.einsum('bsd,dc->bsc', h, w_in[l])
        q, f_logit, i_in, z_a, u, gate_b, gate_c, z_b = jnp.split(proj, splits, axis=-1)

        lb = lower_bounds[l]
        f = lb + (1.0 - lb) * jax.nn.sigmoid(f_logit.astype(jnp.float32))
        log_f = jnp.log(f)
        k = 1.0 - f
        hs = (bsz, s, HGRN_HEADS, HGRN_HEAD_DIM)
        o_a = hgrn2_chunkwise(q.reshape(hs), log_f.reshape(hs), k.reshape(hs), i_in.reshape(hs))
        o_a = grouped_rmsnorm(o_a.reshape(bsz, s, D_HGRN).astype(x.dtype),
                              hgrn_norm_gain[l], HGRN_HEADS)
        o_a = o_a * jax.nn.silu(z_a)

        y_b = gate_b * causal_depthwise_conv(gate_c * u, conv_w[l])
        o_b = grouped_rmsnorm(y_b, conv_norm_gain[l], CONV_GROUPS) * jax.nn.silu(z_b)

        mixed = jnp.concatenate([o_a, o_b], axis=-1)
        x = x + jnp.einsum('bsc,cd->bsd', mixed, w_out[l])
    return rmsnorm(x, final_norm_gain)
```

```cpp
#include <hip/hip_runtime.h>
#include <cstdio>
#include <cstdint>
namespace pg8 {
#define PG8_LAS __attribute__((address_space(3)))
typedef unsigned short bf16_t;
typedef short bf16x8 __attribute__((ext_vector_type(8)));
typedef float f32x4 __attribute__((ext_vector_type(4)));
typedef unsigned u32x4 __attribute__((ext_vector_type(4)));
constexpr int BM = 256, BK = 64, HALF = 128, HTB = HALF * BK * 2  , STAGE_BYTES = 8 * HTB, NXCD = 8, WGM = 8;

__host__ __device__ __forceinline__ int lds_byte(int r, int c) { const int st = (r >> 4) * 2 + (c >> 5), rr = r & 15, cc = c & 31, ob = rr * 64 + cc * 2; return st * 1024 + (ob ^ (((ob >> 9) & 1) << 5)); }
__host__ __device__ __forceinline__ void stage_rc(int b, int& R, int& C) { const int st = b / 1024, sb = b % 1024, swz = sb ^ (((sb >> 9) & 1) << 5); R = (st >> 1) * 16 + swz / 64; C = (st & 1) * 32 + (swz % 64) / 2; }
__host__ __device__ __forceinline__ int perm32(int rho) { const int n = rho >> 4, i = rho & 15; return 8 * (i >> 2) + 4 * n + (i & 3); }

struct Unit { int pm, pn; };
struct Gemm { const bf16_t* A; const bf16_t* Bt; int M, N, K; };

struct StaticOrder {
    int nM, nN, nwg, G, c;
    __host__ __device__ void init(int M, int N, int G_, int c_) { nM = M / BM; nN = N / BM; nwg = nM * nN; G = G_; c = c_; }
    __host__ __device__ bool next(int i, Unit& u) const {
        const long L = (long)i * G + c; if (L >= nwg) return false;
        int wgid = (int)L; { const int q = nwg / NXCD, r = nwg % NXCD, xcd = wgid % NXCD, off = wgid / NXCD; wgid = (xcd < r ? xcd * (q + 1) : r * (q + 1) + (xcd - r) * q) + off; }
        const int nig = WGM * nN, gid = wgid / nig, fm = gid * WGM, gsz = (nM - fm) < WGM ? (nM - fm) : WGM;
        u.pm = fm + ((wgid % nig) % gsz); u.pn = (wgid % nig) / gsz; return true;
    }
    __device__ __forceinline__ void a_ready(const Unit&) const {}
    __device__ __forceinline__ void done(const Unit&) const {}
};

typedef __bf16 bf16x2_t __attribute__((ext_vector_type(2)));
typedef float f32x2_t __attribute__((ext_vector_type(2)));
__device__ __forceinline__ unsigned cvt_pk_bf16(float lo, float hi) { f32x2_t v = {lo, hi}; bf16x2_t r = __builtin_convertvector(v, bf16x2_t); return __builtin_bit_cast(unsigned, r); }
typedef float f32x2 __attribute__((ext_vector_type(2)));
struct EpiBf16 {
    static constexpr bool PERM = true, AFTER_DRAIN = false;
    bf16_t* O; int ldc;
    __device__ __forceinline__ void operator()(const f32x4 (&acc)[2][2][4][2], const Unit& u, int wr, int wc, int fr, int fq) const {
        const int row0 = u.pm * BM + wr * 64 + fr; const int col0 = u.pn * BM + wc * 32 + 8 * fq;
#pragma unroll
        for (int ai = 0; ai < 2; ++ai)
#pragma unroll
            for (int m = 0; m < 4; ++m) { bf16_t* rowp = O + (size_t)(row0 + ai * HALF + m * 16) * ldc + col0;
#pragma unroll
                for (int bj = 0; bj < 2; ++bj) { const f32x4 v0 = acc[ai][bj][m][0], v1 = acc[ai][bj][m][1];
                    u32x4 w; w.x = cvt_pk_bf16(v0[0], v0[1]); w.y = cvt_pk_bf16(v0[2], v0[3]); w.z = cvt_pk_bf16(v1[0], v1[1]); w.w = cvt_pk_bf16(v1[2], v1[3]);
                    *(u32x4*)(rowp + bj * HALF) = w; } }
    }
};

struct PanelStats {
    unsigned* xbuf;
    unsigned* cnt;
    unsigned* tmo;
    int ntn; float eps;
    unsigned code;
    __device__ __forceinline__ bool run(const f32x4 (&v)[2][2][4][2], const Unit& u, int wr, int wc, int fr, int fq, PG8_LAS unsigned char* lds, int wid, int lane) const {
        PG8_LAS float* P = (PG8_LAS float*)lds;
        PG8_LAS float* S = (PG8_LAS float*)(lds + 8192);
        PG8_LAS unsigned* flag = (PG8_LAS unsigned*)(lds + 8192 + 2048);
#pragma unroll
        for (int ai = 0; ai < 2; ++ai)
#pragma unroll
            for (int m = 0; m < 4; ++m) {
                float q = 0.f;
#pragma unroll
                for (int bj = 0; bj < 2; ++bj)
#pragma unroll
                    for (int n = 0; n < 2; ++n) { const f32x4 d = v[ai][bj][m][n]; q += (d[0] * d[0] + d[1] * d[1]) + (d[2] * d[2] + d[3] * d[3]); }
                q += __shfl_xor(q, 16); q += __shfl_xor(q, 32);
                if (fq == 0) P[(ai * HALF + wr * 64 + m * 16 + fr) * 4 + wc] = q;
            }
        asm volatile("s_waitcnt lgkmcnt(0)" ::: "memory"); __builtin_amdgcn_s_barrier(); asm volatile("" ::: "memory");
        const int row = wid * 32 + (lane & 31);
        if (lane < 32) {
            const float ss = (P[row * 4 + 0] + P[row * 4 + 1]) + (P[row * 4 + 2] + P[row * 4 + 3]);
            unsigned long long* slot = (unsigned long long*)xbuf + ((size_t)(u.pm * BM + row) * 4 + u.pn);
            __hip_atomic_store(slot, ((unsigned long long)__float_as_uint(ss) << 32) | __float_as_uint(ss), __ATOMIC_RELAXED, __HIP_MEMORY_SCOPE_AGENT);
        }
        asm volatile("s_waitcnt vmcnt(0)" ::: "memory");
        if (lane == 0) __hip_atomic_fetch_add(cnt + 64 * u.pm, 1u, __ATOMIC_RELAXED, __HIP_MEMORY_SCOPE_AGENT);
        if (wid == 0) {
            bool dead = false; const unsigned long long t0 = __builtin_amdgcn_s_memrealtime(); const unsigned want = 8u * (unsigned)ntn;
            for (;;) {
                if ((unsigned)__builtin_amdgcn_readfirstlane(__hip_atomic_load(cnt + 64 * u.pm, __ATOMIC_RELAXED, __HIP_MEMORY_SCOPE_AGENT)) >= want) break;
                if (__builtin_amdgcn_s_memrealtime() - t0 > 2000000ull) {
                    if (lane == 0) { unsigned expect = 0u; __hip_atomic_compare_exchange_strong(tmo + 1, &expect, code | (unsigned)(u.pm & 0xff), __ATOMIC_RELAXED, __ATOMIC_RELAXED, __HIP_MEMORY_SCOPE_AGENT);
                                     __hip_atomic_store(tmo, 1u, __ATOMIC_RELAXED, __HIP_MEMORY_SCOPE_AGENT); }
                    dead = true; break; }
                __builtin_amdgcn_s_sleep(2);
            }
            __builtin_amdgcn_fence(__ATOMIC_ACQUIRE, "agent");
            if (lane == 0) flag[0] = dead ? 1u : 0u;
        }
        asm volatile("s_waitcnt vmcnt(0) lgkmcnt(0)" ::: "memory"); __builtin_amdgcn_s_barrier(); asm volatile("" ::: "memory");
        const bool bad = flag[0] != 0u;
        if (lane < 32) {
            const unsigned long long* slot = (const unsigned long long*)xbuf + (size_t)(u.pm * BM + row) * 4; float q = 0.f;
#pragma unroll
            for (int t = 0; t < 4; ++t) { if (t < ntn) { const unsigned long long w = __hip_atomic_load(slot + t, __ATOMIC_RELAXED, __HIP_MEMORY_SCOPE_AGENT); q += __uint_as_float((unsigned)w); } }
            S[row] = 1.0f / sqrtf(q / (256.0f * (float)ntn) + eps);
        }
        asm volatile("s_waitcnt lgkmcnt(0)" ::: "memory"); __builtin_amdgcn_s_barrier(); asm volatile("" ::: "memory");
        return bad;
    }
};
struct EpiRmsRes {
    static constexpr bool PERM = false, AFTER_DRAIN = true;
    const float* base; float* out; int ldc; const float* gain; PanelStats st; unsigned poison;
    __device__ __forceinline__ void fused(f32x4 (&acc)[2][2][4][2], const Unit& u, int wr, int wc, int fr, int fq, PG8_LAS unsigned char* lds, int wid, int lane) const {
        const PG8_LAS float* S = (const PG8_LAS float*)(lds + 8192);
        const int col0 = u.pn * BM + wc * 32 + 4 * fq;
#pragma unroll
        for (int ai = 0; ai < 2; ++ai)
#pragma unroll
            for (int m = 0; m < 4; ++m) { const size_t off = (size_t)(u.pm * BM + ai * HALF + wr * 64 + m * 16 + fr) * ldc + col0;
#pragma unroll
                for (int bj = 0; bj < 2; ++bj)
#pragma unroll
                    for (int n = 0; n < 2; ++n) acc[ai][bj][m][n] += *(const f32x4*)(base + off + bj * HALF + n * 16);
                if (m & 1) asm volatile("" ::: "memory"); }
        const bool bad = st.run(acc, u, wr, wc, fr, fq, lds, wid, lane) || poison != 0u;
        const float qnan = __builtin_nanf("");
        f32x4 gv[2][2];
#pragma unroll
        for (int bj = 0; bj < 2; ++bj)
#pragma unroll
            for (int n = 0; n < 2; ++n) gv[bj][n] = *(const f32x4*)(gain + col0 + bj * HALF + n * 16);
#pragma unroll
        for (int ai = 0; ai < 2; ++ai)
#pragma unroll
            for (int m = 0; m < 4; ++m) { const int r = ai * HALF + wr * 64 + m * 16 + fr; const float sr = S[r]; const size_t off = (size_t)(u.pm * BM + r) * ldc + col0;
#pragma unroll
                for (int bj = 0; bj < 2; ++bj)
#pragma unroll
                    for (int n = 0; n < 2; ++n) { f32x4 o = acc[ai][bj][m][n] * sr * gv[bj][n];
                        if (bad) o = (f32x4){qnan, qnan, qnan, qnan}; *(f32x4*)(out + off + bj * HALF + n * 16) = o; } }
    }
};

struct EpiResF32 {
    static constexpr bool PERM = false, AFTER_DRAIN = false;
    const float* base; float* out; int ldc;
    __device__ __forceinline__ void operator()(const f32x4 (&acc)[2][2][4][2], const Unit& u, int wr, int wc, int fr, int fq) const {
        const int col0 = u.pn * BM + wc * 32 + 4 * fq;
#pragma unroll
        for (int ai = 0; ai < 2; ++ai)
#pragma unroll
            for (int m = 0; m < 4; ++m) { const size_t off = (size_t)(u.pm * BM + ai * HALF + wr * 64 + m * 16 + fr) * ldc + col0;
#pragma unroll
                for (int bj = 0; bj < 2; ++bj)
#pragma unroll
                    for (int n = 0; n < 2; ++n) *(f32x4*)(out + off + bj * HALF + n * 16) = acc[ai][bj][m][n] + *(const f32x4*)(base + off + bj * HALF + n * 16); }
    }
};
template <class Epi, class Sched, bool ALIGN_EPI = false, bool SP2 = false>
__device__ __forceinline__ void gemm_phase(PG8_LAS unsigned char* lds, const Gemm g, const Sched& S, const Epi& E) {
    const int tid = threadIdx.x, wid = __builtin_amdgcn_readfirstlane(tid >> 6), lane = tid & 63, wr = wid >> 2, wc = wid & 3, fr = lane & 15, fq = lane >> 4;
    const int K = g.K, nt = K / BK;
    unsigned voffA[2], voffB[2];
#pragma unroll
    for (int i = 0; i < 2; ++i) { int R, C; stage_rc(tid * 16 + i * 8192, R, C); const int Rb = Epi::PERM ? ((R & ~31) + perm32(R & 31)) : R;
        voffA[i] = (unsigned)(R * K + C) * 2u; voffB[i] = (unsigned)(Rb * K + C) * 2u; }
    const size_t kstep = (size_t)(BK * 2);
    const size_t hstep = (size_t)HALF * K * 2;
    const size_t tstep = 2 * hstep;
    const unsigned ldsw = (unsigned)wid * 1024u;
    const int aoff = lds_byte(wr * 64 + fr, fq * 8), boff = lds_byte(wc * 32 + fr, fq * 8);
#define PG8_SA(b, h) (((b) * 2 + (h)) * HTB)
#define PG8_SB(b, h) ((4 + (b) * 2 + (h)) * HTB)
#define PG8_STAGE(bufoff, gbase, voff) do { _Pragma("unroll") for (int _i = 0; _i < 2; ++_i) \
        __builtin_amdgcn_global_load_lds((const unsigned*)((const char*)(gbase) + (voff)[_i]), (PG8_LAS unsigned*)(lds + (bufoff) + ldsw + _i * 8192), 16, 0, 0); } while (0)
#define PG8_LDA(dst, b, h) do { _Pragma("unroll") for (int m = 0; m < 4; ++m) _Pragma("unroll") for (int k = 0; k < 2; ++k) dst[m][k] = *(const PG8_LAS bf16x8*)(lds + PG8_SA(b, h) + aoff + m * 2048 + k * 1024); } while (0)
#define PG8_LDB(dst, b, h) do { _Pragma("unroll") for (int n = 0; n < 2; ++n) _Pragma("unroll") for (int k = 0; k < 2; ++k) dst[n][k] = *(const PG8_LAS bf16x8*)(lds + PG8_SB(b, h) + boff + n * 2048 + k * 1024); } while (0)
#define PG8_MMA(ai, bj, At, Bt) do { __builtin_amdgcn_s_setprio(1); _Pragma("unroll") for (int m = 0; m < 4; ++m) _Pragma("unroll") for (int n = 0; n < 2; ++n) _Pragma("unroll") for (int k = 0; k < 2; ++k) \
        acc[ai][bj][m][n] = __builtin_amdgcn_mfma_f32_16x16x32_bf16(Bt[n][k], At[m][k], acc[ai][bj][m][n], 0, 0, 0); __builtin_amdgcn_s_setprio(0); } while (0)
#define PG8_WAIT_V(n) asm volatile("s_waitcnt vmcnt(" #n ")" ::: "memory")
#define PG8_WAIT_L(n) asm volatile("s_waitcnt lgkmcnt(" #n ")" ::: "memory")
#define PG8_BAR __builtin_amdgcn_s_barrier()
#define PG8_SCHED __builtin_amdgcn_sched_barrier(0)
    Unit cur, nxt; int ui = 0;
    if (!S.next(0, cur)) return;
    f32x4 acc[2][2][4][2];
#pragma unroll
    for (int a = 0; a < 2; ++a)
#pragma unroll
        for (int b = 0; b < 2; ++b)
#pragma unroll
            for (int m = 0; m < 4; ++m)
#pragma unroll
                for (int n = 0; n < 2; ++n) acc[a][b][m][n] = (f32x4){0.f, 0.f, 0.f, 0.f};
    bf16x8 At[4][2], B0[2][2], B1[2][2];
    const char* cA = (const char*)g.A + (size_t)cur.pm * tstep; const char* cB = (const char*)g.Bt + (size_t)cur.pn * tstep;
    S.a_ready(cur);
    if constexpr (SP2) {
        PG8_STAGE(PG8_SB(0, 0), cB, voffB); PG8_STAGE(PG8_SB(0, 1), cB + hstep, voffB); PG8_STAGE(PG8_SA(0, 0), cA, voffA); PG8_STAGE(PG8_SA(0, 1), cA + hstep, voffA);
        if (wr == 1) PG8_BAR;
        PG8_WAIT_V(2); PG8_BAR;
        PG8_STAGE(PG8_SB(1, 0), cB + kstep, voffB); PG8_STAGE(PG8_SA(1, 0), cA + kstep, voffA); PG8_STAGE(PG8_SB(1, 1), cB + hstep + kstep, voffB);
        PG8_WAIT_V(6); PG8_BAR;
    } else {
        PG8_STAGE(PG8_SB(0, 0), cB, voffB); PG8_STAGE(PG8_SA(0, 0), cA, voffA); PG8_STAGE(PG8_SB(0, 1), cB + hstep, voffB); PG8_STAGE(PG8_SA(0, 1), cA + hstep, voffA);
        if (wr == 1) PG8_BAR;
        PG8_WAIT_V(4); PG8_BAR;
        PG8_STAGE(PG8_SB(1, 0), cB + kstep, voffB); PG8_STAGE(PG8_SA(1, 0), cA + kstep, voffA); PG8_STAGE(PG8_SB(1, 1), cB + hstep + kstep, voffB);
        PG8_WAIT_V(6); PG8_BAR;
    }
    for (;;) {
        const bool has_next = S.next(ui + 1, nxt);
        const char* nA = has_next ? (const char*)g.A + (size_t)nxt.pm * tstep : cA; const char* nB = has_next ? (const char*)g.Bt + (size_t)nxt.pn * tstep : cB;
        for (int t = 0; t < nt; t += 2) {
            const bool last = (t == nt - 2);
            const char* a1 = cA + (size_t)(t + 1) * kstep;
            const char* a2 = last ? nA : cA + (size_t)(t + 2) * kstep; const char* b2 = last ? nB : cB + (size_t)(t + 2) * kstep;
            const char* a3 = a2 + kstep; const char* b3 = b2 + kstep;
            if (last && has_next) S.a_ready(nxt);
            if constexpr (SP2) {
            PG8_LDB(B0, 0, 0); PG8_LDB(B1, 0, 1); PG8_SCHED; PG8_LDA(At, 0, 0); PG8_STAGE(PG8_SA(1, 1), a1 + hstep, voffA);
            PG8_WAIT_V(8); PG8_WAIT_L(0); PG8_BAR; PG8_MMA(0, 0, At, B0); PG8_MMA(0, 1, At, B1); PG8_BAR; PG8_SCHED;
            PG8_LDA(At, 0, 1); PG8_STAGE(PG8_SB(0, 0), b2, voffB); PG8_STAGE(PG8_SB(0, 1), b2 + hstep, voffB); PG8_STAGE(PG8_SA(0, 0), a2, voffA);
            PG8_WAIT_V(8); PG8_WAIT_L(0); PG8_BAR; PG8_MMA(1, 0, At, B0); PG8_MMA(1, 1, At, B1); PG8_BAR; PG8_SCHED;
            PG8_LDB(B0, 1, 0); PG8_LDB(B1, 1, 1); PG8_SCHED; PG8_LDA(At, 1, 0); PG8_STAGE(PG8_SA(0, 1), a2 + hstep, voffA);
            PG8_WAIT_V(8); PG8_WAIT_L(0); PG8_BAR; PG8_MMA(0, 0, At, B0); PG8_MMA(0, 1, At, B1); PG8_BAR; PG8_SCHED;
            PG8_LDA(At, 1, 1); PG8_STAGE(PG8_SB(1, 0), b3, voffB); PG8_STAGE(PG8_SB(1, 1), b3 + hstep, voffB); PG8_STAGE(PG8_SA(1, 0), a3, voffA);
            PG8_WAIT_V(8); PG8_WAIT_L(0); PG8_BAR; PG8_MMA(1, 0, At, B0); PG8_MMA(1, 1, At, B1); PG8_BAR; PG8_SCHED;
            } else {
            PG8_LDB(B0, 0, 0); PG8_SCHED; PG8_LDA(At, 0, 0); PG8_STAGE(PG8_SA(1, 1), a1 + hstep, voffA);
            PG8_WAIT_L(8); PG8_BAR; PG8_WAIT_L(0); PG8_MMA(0, 0, At, B0); PG8_BAR; PG8_SCHED;
            PG8_LDB(B1, 0, 1); PG8_STAGE(PG8_SB(0, 0), b2, voffB);
            PG8_BAR; PG8_WAIT_L(0); PG8_MMA(0, 1, At, B1); PG8_BAR;
            PG8_LDA(At, 0, 1); PG8_STAGE(PG8_SA(0, 0), a2, voffA);
            PG8_BAR; PG8_WAIT_L(0); PG8_MMA(1, 0, At, B0); PG8_BAR; PG8_SCHED;
            PG8_STAGE(PG8_SB(0, 1), b2 + hstep, voffB);
            PG8_WAIT_V(6); PG8_BAR; PG8_MMA(1, 1, At, B1); PG8_BAR;
            PG8_LDB(B0, 1, 0); PG8_SCHED; PG8_LDA(At, 1, 0); PG8_STAGE(PG8_SA(0, 1), a2 + hstep, voffA);
            PG8_WAIT_L(8); PG8_BAR; PG8_WAIT_L(0); PG8_MMA(0, 0, At, B0); PG8_BAR; PG8_SCHED;
            PG8_LDB(B1, 1, 1); PG8_STAGE(PG8_SB(1, 0), b3, voffB);
            PG8_BAR; PG8_WAIT_L(0); PG8_MMA(0, 1, At, B1); PG8_BAR;
            PG8_LDA(At, 1, 1); PG8_STAGE(PG8_SA(1, 0), a3, voffA);
            PG8_BAR; PG8_WAIT_L(0); PG8_MMA(1, 0, At, B0); PG8_BAR; PG8_SCHED;
            PG8_STAGE(PG8_SB(1, 1), b3 + hstep, voffB);
            PG8_WAIT_V(6); PG8_BAR; PG8_MMA(1, 1, At, B1); PG8_BAR;
            }
        }
        if constexpr (ALIGN_EPI) { if (wr == 0) PG8_BAR; }
        if constexpr (!Epi::AFTER_DRAIN) { E(acc, cur, wr, wc, fr, fq); S.done(cur); }
        if (!has_next) break;
#pragma unroll
        for (int a = 0; a < 2; ++a)
#pragma unroll
            for (int b = 0; b < 2; ++b)
#pragma unroll
                for (int m = 0; m < 4; ++m)
#pragma unroll
                    for (int n = 0; n < 2; ++n) acc[a][b][m][n] = (f32x4){0.f, 0.f, 0.f, 0.f};
        cur = nxt; cA = nA; cB = nB; ++ui;
        if constexpr (ALIGN_EPI) { if (wr == 1) PG8_BAR; }
    }
    PG8_WAIT_V(0);
    if constexpr (!ALIGN_EPI) { if (wr == 0) PG8_BAR; }
    PG8_BAR;
    if constexpr (Epi::AFTER_DRAIN) { E.fused(acc, cur, wr, wc, fr, fq, lds, wid, lane); S.done(cur); }
#undef PG8_SA
#undef PG8_SB
#undef PG8_STAGE
#undef PG8_LDA
#undef PG8_LDB
#undef PG8_MMA
#undef PG8_WAIT_V
#undef PG8_WAIT_L
#undef PG8_BAR
#undef PG8_SCHED
}
}

#ifndef PG8_SP2
#define PG8_SP2 true
#endif
#ifndef PG8_ALIGN
#define PG8_ALIGN true
#endif
#ifndef PG8_SP2
#define PG8_SP2 true
#endif
#ifndef PG8_ALIGN
#define PG8_ALIGN true
#endif
constexpr int NWAVES = 8;
#ifndef MK_N_LAUNCHES
#define MK_N_LAUNCHES 7
#endif
constexpr int N_LAUNCHES = MK_N_LAUNCHES;
constexpr int PER_PHASE = 7;

constexpr int BATCH = 8, SEQ = 2048, DM = 1024, NIN = 4096, DHG = 512, DCV = 512, HD = 128, NH = 4, CHK = 64, NCH = SEQ / CHK, NG_CONV = 8;
constexpr int M = BATCH * SEQ;
constexpr int NUNIT = BATCH * NH * NCH;
constexpr float EPS = 1e-6f;
constexpr int PC_Q = 0, PC_F = 512, PC_I = 1024, PC_ZA = 1536, PC_U = 2048, PC_B = 2560, PC_C = 3072, PC_ZB = 3584;

constexpr size_t MiB = 1u << 20;
constexpr size_t WS_CTL = 0, CTL_ZERO_BYTES = 1 * MiB;
constexpr size_t WS_WIN = 2 * MiB, WS_WOUT = 10 * MiB;
constexpr size_t WS_X = 12 * MiB;
constexpr size_t WS_DEC = 13 * MiB;
constexpr size_t WS_XN = 16 * MiB;
constexpr size_t WS_ST = 16 * MiB;
constexpr size_t WS_PROJ = 48 * MiB;
constexpr size_t WS_MIX = 176 * MiB;
constexpr size_t WS_UT = 208 * MiB;
constexpr size_t WS_END = 240 * MiB;
constexpr int CW_TMO = 0, CW_CODE = 1;
constexpr int CW_BAR = 4096;
constexpr int CW_SEAM = 16384;
constexpr int RING_OFF = 0, RING_BYTES = 131072;
constexpr int LDSCTL_OFF = RING_BYTES, MISC_OFF = LDSCTL_OFF + 320;
constexpr int LDS_BYTES = 147456;
constexpr int L_RAWF = 0, L_RAWV = 16384, L_RAWQ = 32768;
constexpr int L_ST = 0, ST_RS = 272;
constexpr int L_QD = 49152, QD_RS = 272;
constexpr int L_KI = L_QD + 64 * QD_RS;
constexpr int L_KET = L_QD, T_RS = 144;
constexpr int L_VT = L_KI + 64 * QD_RS;
constexpr int L_P = L_VT + 128 * T_RS;
constexpr int L_SEGT = L_P + 64 * T_RS;
constexpr int L_NS = L_SEGT + 2048;
static_assert(L_NS + 512 <= RING_BYTES && L_KET + 128 * T_RS <= L_VT, "HGRN LDS map");
#define GAS __attribute__((address_space(1)))
#define LAS __attribute__((address_space(3)))
typedef unsigned short bf16;
typedef unsigned v4u __attribute__((ext_vector_type(4)));
typedef float f32x4 __attribute__((ext_vector_type(4)));
typedef short bf16x8 __attribute__((ext_vector_type(8)));
typedef GAS unsigned gu32;
typedef GAS unsigned long long gu64;
#define RLX_AGENT __ATOMIC_RELAXED, __HIP_MEMORY_SCOPE_AGENT
#define LDS_WAIT() asm volatile("s_waitcnt lgkmcnt(0)" ::: "memory")
#define VM_WAIT() asm volatile("s_waitcnt vmcnt(0)" ::: "memory")
__device__ __forceinline__ unsigned long long rt() { return __builtin_amdgcn_s_memrealtime(); }
__device__ __forceinline__ unsigned f2bf(float f) { unsigned u = __builtin_bit_cast(unsigned, f); return (u + 0x7fffu + ((u >> 16) & 1u)) >> 16; }
__device__ __forceinline__ unsigned pk2(float lo, float hi) { return f2bf(lo) | (f2bf(hi) << 16); }

#define XB_TMO      128
#define XB_XCNT(j)  (256  + 64 * (j))
#define XB_XSUB(j)  (1280 + 64 * (j))
#define XB_XGEN(j)  (2304 + 64 * (j))
#define XB_TOP      3328
#define XB_TOPGEN   3392
#define XCD_BAR_WORDS 3456
#define XB_SPIN_CAP (1u << 18)

__device__ __forceinline__ unsigned xb_ld(unsigned* p)              { return __hip_atomic_load(p, __ATOMIC_RELAXED, __HIP_MEMORY_SCOPE_AGENT); }
__device__ __forceinline__ unsigned xb_add(unsigned* p, unsigned v) { return __hip_atomic_fetch_add(p, v, __ATOMIC_RELAXED, __HIP_MEMORY_SCOPE_AGENT); }
__device__ __forceinline__ unsigned xb_xcc_id() { return (unsigned)__builtin_amdgcn_s_getreg((3 << 11) | 20) & 0xFu; }
#define XB_SPIN(cond, bar) do { unsigned _sp = 0; while (cond) { __builtin_amdgcn_s_sleep(1); \
    if ((++_sp & 255u) == 0u) { if (xb_ld(&(bar)[XB_TMO])) break; if (_sp > XB_SPIN_CAP) { atomicAdd(&(bar)[XB_TMO], 1u); break; } } } } while (0)

struct XcdBarrier {
    unsigned* bar; unsigned x;
    volatile LAS unsigned* st;
};

__device__ __forceinline__ XcdBarrier xcd_barrier_post(unsigned* bar, volatile LAS unsigned* st) {
    XcdBarrier b; b.bar = bar; b.x = xb_xcc_id(); b.st = st;
    if (threadIdx.x == 0) (void)xb_add(&bar[XB_XCNT(b.x)], 1u);
    return b;
}
__device__ __forceinline__ void xcd_barrier_complete(unsigned* bar, unsigned x, unsigned& nloc, unsigned& nx) {
    const unsigned G = gridDim.x * gridDim.y * gridDim.z;
    unsigned sum, cnt, mine, sp = 0u;
    for (;;) {
        sum = 0u; cnt = 0u; mine = 0u;
#pragma unroll
        for (unsigned j = 0; j < 16; ++j) { const unsigned c = xb_ld(&bar[XB_XCNT(j)]); sum += c; cnt += (c > 0u) ? 1u : 0u; mine = (j == x) ? c : mine; }
        if (sum == G) break;
        __builtin_amdgcn_s_sleep(1);
        if ((++sp & 255u) == 0u) { if (xb_ld(&bar[XB_TMO])) break; if (sp > XB_SPIN_CAP) { atomicAdd(&bar[XB_TMO], 1u); break; } }
    }
    nloc = mine > 0u ? mine : 1u; nx = cnt > 0u ? cnt : 1u;
}

__device__ __forceinline__ void xcd_barrier(const XcdBarrier& b) {
    asm volatile("s_waitcnt vmcnt(0)" ::: "memory");
    __syncthreads();
    if (threadIdx.x == 0) {
        unsigned* bar = b.bar;
        __builtin_amdgcn_s_waitcnt(0);
        unsigned nloc = b.st[0], nx = b.st[1];
        if (nloc == 0u) { xcd_barrier_complete(bar, b.x, nloc, nx); b.st[0] = nloc; b.st[1] = nx; }
        const unsigned old = xb_add(&bar[XB_XSUB(b.x)], 1u);
        const unsigned gen = old / nloc;
        if (old + 1u == (gen + 1u) * nloc) {
            __builtin_amdgcn_fence(__ATOMIC_RELEASE, "agent");
            asm volatile("s_waitcnt vmcnt(0)" ::: "memory");
            const unsigned og = xb_add(&bar[XB_TOP], 1u);
            const unsigned tg = og / nx;
            if (og + 1u == (tg + 1u) * nx) xb_add(&bar[XB_TOPGEN], 1u);
            else XB_SPIN(xb_ld(&bar[XB_TOPGEN]) == tg, bar);
            __builtin_amdgcn_fence(__ATOMIC_ACQUIRE, "agent");
            xb_add(&bar[XB_XGEN(b.x)], 1u);
            asm volatile("s_waitcnt vmcnt(0)" ::: "memory");
        } else {
            XB_SPIN(xb_ld(&bar[XB_XGEN(b.x)]) == gen, bar);
            __builtin_amdgcn_fence(__ATOMIC_ACQUIRE, "agent");
            asm volatile("s_waitcnt vmcnt(0)" ::: "memory");
        }
    }
    __syncthreads();
}

typedef unsigned v2u __attribute__((ext_vector_type(2)));
struct Frame {
    LAS unsigned char* lds;
    volatile LAS unsigned* MISC;
    gu32* ctl;
    int tid, lane, wave;
    int vcu, G;
    const float* x; float* out;
    const float *norm_gain, *w_in, *lb_logits, *conv_w, *hg_gain, *cv_gain, *w_out, *fin_gain;
    bf16 *WinT, *WoutT, *XN, *PROJ, *MIX, *UT, *ST; float* DEC;
};
__device__ __forceinline__ float wave_sum(float v) {
#pragma unroll
    for (int o = 1; o < 64; o <<= 1) v += __shfl_xor(v, o);
    return v;
}
__device__ __forceinline__ unsigned cvtpk(float lo, float hi) { return pg8::cvt_pk_bf16(lo, hi); }
__device__ __forceinline__ float bflo(unsigned w) { return __uint_as_float(w << 16); }
__device__ __forceinline__ float bfhi(unsigned w) { return __uint_as_float(w & 0xffff0000u); }
__device__ __forceinline__ float fexp(float x) { return __builtin_amdgcn_exp2f(x * 1.44269504089f); }
__device__ __forceinline__ float sigmoidf(float x) { return __builtin_amdgcn_rcpf(1.0f + fexp(-x)); }

__device__ __forceinline__ void p0_transpose_item(const float* W, int K, int N, bf16* WT, LAS float* scr, int item, int lane) {
    const int nblk = N / 32, kb = item / nblk, nb = item % nblk, k0 = 64 * kb, n0 = 32 * nb;
#pragma unroll 8
    for (int i = 0; i < 32; ++i) { const int kk = 2 * i + (lane >> 5); scr[kk * 33 + (lane & 31)] = W[(size_t)(k0 + kk) * N + n0 + (lane & 31)]; }
    LDS_WAIT(); asm volatile("" ::: "memory");
    const int c = lane & 7;
#pragma unroll
    for (int j = 0; j < 4; ++j) { const int n = (lane >> 3) + 8 * j; const LAS float* s = scr + (8 * c) * 33 + n;
        v4u o; o.x = cvtpk(s[0 * 33], s[1 * 33]); o.y = cvtpk(s[2 * 33], s[3 * 33]); o.z = cvtpk(s[4 * 33], s[5 * 33]); o.w = cvtpk(s[6 * 33], s[7 * 33]);
        *(GAS v4u*)(WT + (size_t)(n0 + n) * K + k0 + 8 * c) = o; }
    LDS_WAIT(); asm volatile("" ::: "memory");
}
__device__ __forceinline__ void rms_row_to_bf16(Frame& F, const float* xrow, bf16* orow) {
    const GAS f32x4* xr = (const GAS f32x4*)xrow + F.lane; const GAS f32x4* gr = (const GAS f32x4*)F.norm_gain + F.lane;
    f32x4 v[4]; float s2 = 0.f;
#pragma unroll
    for (int j = 0; j < 4; ++j) { v[j] = xr[64 * j]; s2 += (v[j].x * v[j].x + v[j].y * v[j].y) + (v[j].z * v[j].z + v[j].w * v[j].w); }
    const float rstd = 1.f / sqrtf(wave_sum(s2) * (1.f / DM) + EPS);
    GAS unsigned long long* o8 = (GAS unsigned long long*)orow + F.lane;
#pragma unroll
    for (int j = 0; j < 4; ++j) { const f32x4 g = gr[64 * j]; o8[64 * j] = (unsigned long long)cvtpk(v[j].x * rstd * g.x, v[j].y * rstd * g.y) | ((unsigned long long)cvtpk(v[j].z * rstd * g.z, v[j].w * rstd * g.w) << 32); }
}
__device__ __forceinline__ void p0_prologue(Frame& F) {
    LAS float* scr = (LAS float*)(F.lds + RING_OFF + F.wave * 16384);
    const int gw = F.vcu * NWAVES + F.wave, NGW = F.G * NWAVES;
    constexpr int I_IN = (DM / 64) * (NIN / 32), I_OUT = (DM / 64) * (DM / 32);
    for (int it = gw; it < I_IN + I_OUT; it += NGW) {
        if (it < I_IN) p0_transpose_item(F.w_in, DM, NIN, F.WinT, scr, it, F.lane);
        else p0_transpose_item(F.w_out, DM, DM, F.WoutT, scr, it - I_IN, F.lane);
    }
    for (int m = gw; m < M; m += NGW) rms_row_to_bf16(F, F.x + (size_t)m * DM, F.XN + (size_t)m * DM);
}

__device__ __forceinline__ void conv_wave(Frame& F, int gw) {
    const int lane = F.lane, c0 = lane * 8, t0 = gw * 8;
    float w0[8], w1[8], w2[8], gn[8];
    { const GAS f32x4* p = (const GAS f32x4*)(F.conv_w + c0); const f32x4 a = p[0], b = p[1]; const f32x4 c = p[DCV / 4], d = p[DCV / 4 + 1]; const f32x4 e = p[2 * DCV / 4], f = p[2 * DCV / 4 + 1];
      const GAS f32x4* g = (const GAS f32x4*)(F.cv_gain + c0); const f32x4 g0 = g[0], g1 = g[1];
#pragma unroll
      for (int k = 0; k < 4; ++k) { w0[k] = a[k]; w0[4 + k] = b[k]; w1[k] = c[k]; w1[4 + k] = d[k]; w2[k] = e[k]; w2[4 + k] = f[k]; gn[k] = g0[k]; gn[4 + k] = g1[k]; } }
    float cm2[8], cm1[8];
    const bool halo = (t0 & (SEQ - 1)) != 0;
    { const bf16* r2 = F.PROJ + (size_t)(t0 - 2) * NIN + c0; const bf16* r1 = r2 + NIN;
      v4u u2 = (v4u){0, 0, 0, 0}, c2 = u2, u1 = u2, c1 = u2;
      if (halo) { u2 = *(const GAS v4u*)(r2 + PC_U); c2 = *(const GAS v4u*)(r2 + PC_C); u1 = *(const GAS v4u*)(r1 + PC_U); c1 = *(const GAS v4u*)(r1 + PC_C); }
#pragma unroll
      for (int k = 0; k < 4; ++k) { cm2[2 * k] = bflo(u2[k]) * bflo(c2[k]); cm2[2 * k + 1] = bfhi(u2[k]) * bfhi(c2[k]); cm1[2 * k] = bflo(u1[k]) * bflo(c1[k]); cm1[2 * k + 1] = bfhi(u1[k]) * bfhi(c1[k]); } }
#pragma unroll
    for (int hb = 0; hb < 2; ++hb) {
        v4u U[4], Bg[4], C[4], Z[4];
#pragma unroll
        for (int k = 0; k < 4; ++k) { const bf16* r = F.PROJ + (size_t)(t0 + hb * 4 + k) * NIN + c0;
            U[k] = *(const GAS v4u*)(r + PC_U); Bg[k] = *(const GAS v4u*)(r + PC_B); C[k] = *(const GAS v4u*)(r + PC_C); Z[k] = *(const GAS v4u*)(r + PC_ZB); }
#pragma unroll
        for (int k = 0; k < 4; ++k) {
            float cu[8], y[8], ss = 0.f;
#pragma unroll
            for (int e = 0; e < 4; ++e) { cu[2 * e] = bflo(U[k][e]) * bflo(C[k][e]); cu[2 * e + 1] = bfhi(U[k][e]) * bfhi(C[k][e]); }
#pragma unroll
            for (int e = 0; e < 8; ++e) { const float bg = (e & 1) ? bfhi(Bg[k][e >> 1]) : bflo(Bg[k][e >> 1]);
                y[e] = bg * (w0[e] * cm2[e] + w1[e] * cm1[e] + w2[e] * cu[e]); ss += y[e] * y[e]; cm2[e] = cm1[e]; cm1[e] = cu[e]; }
            ss += __shfl_xor(ss, 1); ss += __shfl_xor(ss, 2); ss += __shfl_xor(ss, 4);
            const float rstd = 1.f / sqrtf(ss * (1.f / 64.f) + EPS);
            float o[8];
#pragma unroll
            for (int e = 0; e < 8; ++e) { const float z = (e & 1) ? bfhi(Z[k][e >> 1]) : bflo(Z[k][e >> 1]); o[e] = y[e] * rstd * gn[e] * (z * sigmoidf(z)); }
            v4u w; w.x = cvtpk(o[0], o[1]); w.y = cvtpk(o[2], o[3]); w.z = cvtpk(o[4], o[5]); w.w = cvtpk(o[6], o[7]);
            *(GAS v4u*)(F.MIX + (size_t)(t0 + hb * 4 + k) * DM + DHG + c0) = w;
        }
    }
}

__device__ __forceinline__ void gate_pass(Frame& F, int h, int c, int seg, float (&bc)[16], float (&kk)[16], float& g) {
    const float l0 = F.lb_logits[h * HD + c], l1 = F.lb_logits[DHG + h * HD + c];
    const float lb = __builtin_amdgcn_rcpf(1.0f + fexp(l1 - l0));
    const LAS unsigned short* rf = (const LAS unsigned short*)(F.lds + L_RAWF) + (16 * seg) * 128 + c;
    float run = 0.f;
#pragma unroll
    for (int j = 0; j < 16; ++j) { const float xl = __uint_as_float((unsigned)rf[j * 128] << 16);
        const float s = sigmoidf(xl); const float f = lb + (1.0f - lb) * s; kk[j] = 1.0f - f;
        run += __builtin_amdgcn_logf(f) * 0.69314718056f; bc[j] = run; }
    LAS float* segt = (LAS float*)(F.lds + L_SEGT);
    segt[seg * 128 + c] = run;
    LDS_WAIT(); __syncthreads();
    const float s0 = segt[c], s1 = segt[128 + c], s2 = segt[256 + c], s3 = segt[384 + c];
    const float off = (seg > 0 ? s0 : 0.f) + (seg > 1 ? s1 : 0.f) + (seg > 2 ? s2 : 0.f);
    g = (s0 + s1) + (s2 + s3);
#pragma unroll
    for (int j = 0; j < 16; ++j) bc[j] += off;
}
__device__ __forceinline__ void stage_raw_load(const bf16* src, int tid, v4u (&r)[2]) {
#pragma unroll
    for (int i = 0; i < 2; ++i) { const int p = tid + 512 * i; r[i] = *(const GAS v4u*)(src + (size_t)(p >> 4) * NIN + (p & 15) * 8); }
}
__device__ __forceinline__ void stage_raw_store(LAS unsigned char* lds, int off, int tid, const v4u (&r)[2]) {
#pragma unroll
    for (int i = 0; i < 2; ++i) { const int p = tid + 512 * i; *(LAS v4u*)(lds + off + p * 16) = r[i]; }
}
__device__ __forceinline__ void write_T16(LAS unsigned char* base, int c, int seg, const float (&v)[16]) {
    v4u a, b; a.x = cvtpk(v[0], v[1]); a.y = cvtpk(v[2], v[3]); a.z = cvtpk(v[4], v[5]); a.w = cvtpk(v[6], v[7]);
    b.x = cvtpk(v[8], v[9]); b.y = cvtpk(v[10], v[11]); b.z = cvtpk(v[12], v[13]); b.w = cvtpk(v[14], v[15]);
    *(LAS v4u*)(base + c * T_RS + seg * 32) = a; *(LAS v4u*)(base + c * T_RS + seg * 32 + 16) = b;
}

__device__ __forceinline__ void hgrn_step1_unit(Frame& F, int unit) {
    const int n = unit & (NCH - 1), bh = unit >> 5, h = bh & (NH - 1), b = bh >> 2;
    const int tid = F.tid, lane = F.lane, w = F.wave;
    const bf16* prow = F.PROJ + ((size_t)b * SEQ + (size_t)n * CHK) * NIN + h * HD;
    { v4u rf[2], rv[2]; stage_raw_load(prow + PC_F, tid, rf); stage_raw_load(prow + PC_I, tid, rv);
      stage_raw_store(F.lds, L_RAWF, tid, rf); stage_raw_store(F.lds, L_RAWV, tid, rv); }
    LDS_WAIT(); __syncthreads();
    const int c = tid & 127, seg = tid >> 7;
    float bc[16], kk[16], g;
    gate_pass(F, h, c, seg, bc, kk, g);
    { float ke[16];
#pragma unroll
      for (int j = 0; j < 16; ++j) ke[j] = kk[j] * fexp(g - bc[j]);
      write_T16(F.lds + L_KET, c, seg, ke);
      const LAS unsigned short* rv = (const LAS unsigned short*)(F.lds + L_RAWV) + (16 * seg) * 128 + c;
      float vv[16];
#pragma unroll
      for (int j = 0; j < 16; ++j) vv[j] = __uint_as_float((unsigned)rv[j * 128] << 16);
      write_T16(F.lds + L_VT, c, seg, vv);
      if (seg == 0) F.DEC[(size_t)unit * HD + c] = g; }
    LDS_WAIT(); __syncthreads();
    const int i = lane & 15, q = lane >> 4, kg = w & 3, vh = w >> 2;
    f32x4 acc[2][4];
#pragma unroll
    for (int a = 0; a < 2; ++a)
#pragma unroll
        for (int m = 0; m < 4; ++m) acc[a][m] = (f32x4){0.f, 0.f, 0.f, 0.f};
#pragma unroll
    for (int ks = 0; ks < 2; ++ks) {
        bf16x8 A[2], Bv[4];
#pragma unroll
        for (int nn = 0; nn < 2; ++nn) A[nn] = *(const LAS bf16x8*)(F.lds + L_KET + (kg * 32 + 8 * (i >> 2) + 4 * nn + (i & 3)) * T_RS + (ks * 32 + 8 * q) * 2);
#pragma unroll
        for (int m = 0; m < 4; ++m) Bv[m] = *(const LAS bf16x8*)(F.lds + L_VT + (vh * 64 + m * 16 + i) * T_RS + (ks * 32 + 8 * q) * 2);
#pragma unroll
        for (int nn = 0; nn < 2; ++nn)
#pragma unroll
            for (int m = 0; m < 4; ++m) acc[nn][m] = __builtin_amdgcn_mfma_f32_16x16x32_bf16(A[nn], Bv[m], acc[nn][m], 0, 0, 0);
    }
    bf16* ut = F.UT + (size_t)unit * (HD * HD);
#pragma unroll
    for (int m = 0; m < 4; ++m) { v4u o; o.x = cvtpk(acc[0][m][0], acc[0][m][1]); o.y = cvtpk(acc[0][m][2], acc[0][m][3]); o.z = cvtpk(acc[1][m][0], acc[1][m][1]); o.w = cvtpk(acc[1][m][2], acc[1][m][3]);
        *(GAS v4u*)(ut + (vh * 64 + m * 16 + i) * HD + kg * 32 + 8 * q) = o; }
    __syncthreads();
}

__device__ __forceinline__ void scan_phase(Frame& F) {
    const int gt = blockIdx.x * (NWAVES * 64) + F.tid;
    for (int e4 = gt; e4 < BATCH * NH * (HD * HD / 4); e4 += F.G * NWAVES * 64) {
        const int bh = e4 >> 12, e = e4 & 4095, kc4 = (e & 31) * 4;
        const size_t ebase = (size_t)bh * NCH * (HD * HD) + (size_t)e * 4;
        float st[4] = {0.f, 0.f, 0.f, 0.f};
#pragma unroll 1
        for (int nb = 0; nb < NCH; nb += 8) {
            v2u U[8]; f32x4 gg[8];
#pragma unroll
            for (int k = 0; k < 8; ++k) { U[k] = *(const GAS v2u*)(F.UT + ebase + (size_t)(nb + k) * (HD * HD)); gg[k] = *(const GAS f32x4*)(F.DEC + (size_t)(bh * NCH + nb + k) * HD + kc4); }
#pragma unroll
            for (int k = 0; k < 8; ++k) {
                v2u o; o.x = cvtpk(st[0], st[1]); o.y = cvtpk(st[2], st[3]);
                *(GAS v2u*)(F.ST + ebase + (size_t)(nb + k) * (HD * HD)) = o;
                st[0] = fexp(gg[k][0]) * st[0] + bflo(U[k].x); st[1] = fexp(gg[k][1]) * st[1] + bfhi(U[k].x);
                st[2] = fexp(gg[k][2]) * st[2] + bflo(U[k].y); st[3] = fexp(gg[k][3]) * st[3] + bfhi(U[k].y);
            }
        }
    }
}

__device__ __forceinline__ void hgrn_step3_unit(Frame& F, int unit) {
    const int n = unit & (NCH - 1), bh = unit >> 5, h = bh & (NH - 1), b = bh >> 2;
    const int tid = F.tid, lane = F.lane, w = F.wave;
    const size_t row0 = (size_t)b * SEQ + (size_t)n * CHK;
    const bf16* prow = F.PROJ + row0 * NIN + h * HD;
    const int i = lane & 15, q = lane >> 4, tt = w & 3, vh = w >> 2;
    v4u sreg[4];
    { const bf16* st = F.ST + (size_t)unit * (HD * HD);
#pragma unroll
      for (int k = 0; k < 4; ++k) { const int p = tid + 512 * k; sreg[k] = *(const GAS v4u*)(st + (size_t)p * 8); } }
    { v4u rf[2], rv[2], rq[2]; stage_raw_load(prow + PC_F, tid, rf); stage_raw_load(prow + PC_I, tid, rv); stage_raw_load(prow + PC_Q, tid, rq);
      stage_raw_store(F.lds, L_RAWF, tid, rf); stage_raw_store(F.lds, L_RAWV, tid, rv); stage_raw_store(F.lds, L_RAWQ, tid, rq); }
    v4u zreg[2]; f32x4 gnr[2][2];
#pragma unroll
    for (int pr = 0; pr < 2; ++pr) { const int vc = vh * 64 + pr * 32 + 8 * q;
        zreg[pr] = *(const GAS v4u*)(prow + (size_t)(tt * 16 + i) * NIN + PC_ZA + vc);
        gnr[pr][0] = *(const GAS f32x4*)(F.hg_gain + h * HD + vc); gnr[pr][1] = *(const GAS f32x4*)(F.hg_gain + h * HD + vc + 4); }
    LDS_WAIT(); __syncthreads();
    const int c = tid & 127, seg = tid >> 7;
    { float bc[16], kk[16], g;
      gate_pass(F, h, c, seg, bc, kk, g);
      const LAS unsigned short* rq = (const LAS unsigned short*)(F.lds + L_RAWQ) + (16 * seg) * 128 + c;
      const LAS unsigned short* rv = (const LAS unsigned short*)(F.lds + L_RAWV) + (16 * seg) * 128 + c;
      LAS unsigned short* qd = (LAS unsigned short*)(F.lds + L_QD + (16 * seg) * QD_RS) + c;
      LAS unsigned short* ki = (LAS unsigned short*)(F.lds + L_KI + (16 * seg) * QD_RS) + c;
      float vv[16];
#pragma unroll
      for (int j = 0; j < 16; ++j) { const float eb = fexp(bc[j]); const float qv = __uint_as_float((unsigned)rq[j * 128] << 16);
          const unsigned pk = cvtpk(qv * eb, kk[j] * __builtin_amdgcn_rcpf(eb));
          qd[j * (QD_RS / 2)] = (unsigned short)(pk & 0xffffu); ki[j * (QD_RS / 2)] = (unsigned short)(pk >> 16);
          vv[j] = __uint_as_float((unsigned)rv[j * 128] << 16); }
      write_T16(F.lds + L_VT, c, seg, vv); }
    LDS_WAIT(); __syncthreads();
#pragma unroll
    for (int k = 0; k < 4; ++k) { const int p = tid + 512 * k; *(LAS v4u*)(F.lds + L_ST + (p >> 4) * ST_RS + (p & 15) * 16) = sreg[k]; }
    { f32x4 sc[2] = {(f32x4){0.f, 0.f, 0.f, 0.f}, (f32x4){0.f, 0.f, 0.f, 0.f}};
      const int sp = vh;
#pragma unroll
      for (int ks = 0; ks < 4; ++ks) {
          const bf16x8 Bq = *(const LAS bf16x8*)(F.lds + L_QD + (tt * 16 + i) * QD_RS + (ks * 32 + 8 * q) * 2);
#pragma unroll
          for (int nn = 0; nn < 2; ++nn) { const bf16x8 Ak = *(const LAS bf16x8*)(F.lds + L_KI + (sp * 32 + 8 * (i >> 2) + 4 * nn + (i & 3)) * QD_RS + (ks * 32 + 8 * q) * 2);
              sc[nn] = __builtin_amdgcn_mfma_f32_16x16x32_bf16(Ak, Bq, sc[nn], 0, 0, 0); }
      }
      const int t = tt * 16 + i, s0 = sp * 32 + 8 * q;
      float pv[8];
#pragma unroll
      for (int nn = 0; nn < 2; ++nn)
#pragma unroll
          for (int r = 0; r < 4; ++r) pv[4 * nn + r] = (s0 + 4 * nn + r <= t) ? sc[nn][r] : 0.f;
      v4u o; o.x = cvtpk(pv[0], pv[1]); o.y = cvtpk(pv[2], pv[3]); o.z = cvtpk(pv[4], pv[5]); o.w = cvtpk(pv[6], pv[7]);
      *(LAS v4u*)(F.lds + L_P + t * T_RS + s0 * 2) = o; }
    LDS_WAIT(); __syncthreads();
    f32x4 acc[2][2];
#pragma unroll
    for (int pr = 0; pr < 2; ++pr)
#pragma unroll
        for (int nn = 0; nn < 2; ++nn) acc[pr][nn] = (f32x4){0.f, 0.f, 0.f, 0.f};
#pragma unroll
    for (int ks = 0; ks < 2; ++ks) {
        const bf16x8 Bp = *(const LAS bf16x8*)(F.lds + L_P + (tt * 16 + i) * T_RS + (ks * 32 + 8 * q) * 2);
#pragma unroll
        for (int pr = 0; pr < 2; ++pr)
#pragma unroll
            for (int nn = 0; nn < 2; ++nn) { const bf16x8 Av = *(const LAS bf16x8*)(F.lds + L_VT + (vh * 64 + pr * 32 + 8 * (i >> 2) + 4 * nn + (i & 3)) * T_RS + (ks * 32 + 8 * q) * 2);
                acc[pr][nn] = __builtin_amdgcn_mfma_f32_16x16x32_bf16(Av, Bp, acc[pr][nn], 0, 0, 0); }
    }
#pragma unroll
    for (int ks = 0; ks < 4; ++ks) {
        const bf16x8 Bq = *(const LAS bf16x8*)(F.lds + L_QD + (tt * 16 + i) * QD_RS + (ks * 32 + 8 * q) * 2);
#pragma unroll
        for (int pr = 0; pr < 2; ++pr)
#pragma unroll
            for (int nn = 0; nn < 2; ++nn) { const bf16x8 As = *(const LAS bf16x8*)(F.lds + L_ST + (vh * 64 + pr * 32 + 8 * (i >> 2) + 4 * nn + (i & 3)) * ST_RS + (ks * 32 + 8 * q) * 2);
                acc[pr][nn] = __builtin_amdgcn_mfma_f32_16x16x32_bf16(As, Bq, acc[pr][nn], 0, 0, 0); }
    }
    float ss = 0.f;
#pragma unroll
    for (int pr = 0; pr < 2; ++pr)
#pragma unroll
        for (int nn = 0; nn < 2; ++nn) { const f32x4 a = acc[pr][nn]; ss += (a[0] * a[0] + a[1] * a[1]) + (a[2] * a[2] + a[3] * a[3]); }
    ss += __shfl_xor(ss, 16); ss += __shfl_xor(ss, 32);
    LAS float* ns = (LAS float*)(F.lds + L_NS);
    if (q == 0) ns[vh * 64 + tt * 16 + i] = ss;
    LDS_WAIT(); __syncthreads();
    const float rstd = 1.f / sqrtf((ns[tt * 16 + i] + ns[64 + tt * 16 + i]) * (1.f / HD) + EPS);
#pragma unroll
    for (int pr = 0; pr < 2; ++pr) { float o[8];
#pragma unroll
        for (int nn = 0; nn < 2; ++nn)
#pragma unroll
            for (int r = 0; r < 4; ++r) { const int e = 4 * nn + r; const float z = (e & 1) ? bfhi(zreg[pr][e >> 1]) : bflo(zreg[pr][e >> 1]);
                o[e] = acc[pr][nn][r] * rstd * gnr[pr][nn][r] * (z * sigmoidf(z)); }
        v4u wv; wv.x = cvtpk(o[0], o[1]); wv.y = cvtpk(o[2], o[3]); wv.z = cvtpk(o[4], o[5]); wv.w = cvtpk(o[6], o[7]);
        *(GAS v4u*)(F.MIX + (row0 + tt * 16 + i) * DM + h * HD + vh * 64 + pr * 32 + 8 * q) = wv; }
    __syncthreads();
}
struct Args { const float* in[9]; float* out; unsigned char* ws; int ph_lo, ph_hi, li, pad; };
__global__ void __launch_bounds__(NWAVES * 64, 2) hybrid_fwd(Args args) {
    extern __shared__ __attribute__((aligned(16))) unsigned char lds[];
    Frame F;
    F.lds = (LAS unsigned char*)lds;
    F.MISC = (volatile LAS unsigned*)(F.lds + MISC_OFF);
    F.tid = threadIdx.x; F.lane = F.tid & 63; F.wave = __builtin_amdgcn_readfirstlane(F.tid >> 6);
    F.G = gridDim.x; { const int bx = blockIdx.x; F.vcu = (F.G % 8 == 0) ? (bx % 8) * (F.G / 8) + bx / 8 : bx; }
#define GRID_BAR(seam) do { if (N_LAUNCHES == PER_PHASE) { if (F.tid == 0) __hip_atomic_store(F.ctl + CW_TMO, 0xBADBA0u | (unsigned)(seam), RLX_AGENT); } \
    else { xcd_barrier(bar); } } while (0)
    unsigned char* ws = args.ws;
    F.ctl = (gu32*)(ws + WS_CTL);
    F.x = args.in[0]; F.norm_gain = args.in[1]; F.w_in = args.in[2]; F.lb_logits = args.in[3]; F.conv_w = args.in[4];
    F.hg_gain = args.in[5]; F.cv_gain = args.in[6]; F.w_out = args.in[7]; F.fin_gain = args.in[8]; F.out = args.out;
    F.WinT = (bf16*)(ws + WS_WIN); F.WoutT = (bf16*)(ws + WS_WOUT); F.XN = (bf16*)(ws + WS_XN); F.PROJ = (bf16*)(ws + WS_PROJ);
    F.MIX = (bf16*)(ws + WS_MIX); F.UT = (bf16*)(ws + WS_UT); F.ST = (bf16*)(ws + WS_ST); F.DEC = (float*)(ws + WS_DEC);
    for (int u = F.tid; u < (LDS_BYTES - LDSCTL_OFF) / 4; u += NWAVES * 64) ((LAS unsigned*)(F.lds + LDSCTL_OFF))[u] = 0u;
    __syncthreads();
    XcdBarrier bar; bar.bar = (unsigned*)(F.ctl + CW_BAR); bar.x = 0; bar.st = nullptr;
    if (N_LAUNCHES != PER_PHASE) bar = xcd_barrier_post((unsigned*)(F.ctl + CW_BAR), F.MISC + 8);
    const int lo = args.ph_lo, hi = args.ph_hi;
#define IN(k) (lo <= (k) && (k) < hi)
#define BOTH(k) (IN(k) && IN((k) + 1))

    if (IN(0)) { p0_prologue(F); if (BOTH(0)) GRID_BAR(0); }

    if (IN(1)) {
        pg8::Gemm g{F.XN, F.WinT, M, NIN, DM}; pg8::StaticOrder S; S.init(M, NIN, F.G, (int)blockIdx.x);
        pg8::EpiBf16 E{F.PROJ, NIN};
        pg8::gemm_phase<pg8::EpiBf16, pg8::StaticOrder, PG8_ALIGN, PG8_SP2>(F.lds + RING_OFF, g, S, E);
        if (BOTH(1)) GRID_BAR(1);
    }

    if (IN(2)) {
        for (int u = blockIdx.x; u < NUNIT; u += F.G) hgrn_step1_unit(F, u);
        for (int gw = blockIdx.x * NWAVES + F.wave; gw < M / 8; gw += F.G * NWAVES) conv_wave(F, gw);
        if (BOTH(2)) GRID_BAR(2);
    }

    if (IN(3)) { scan_phase(F); if (BOTH(3)) GRID_BAR(3); }

    if (IN(4)) {
        for (int u = blockIdx.x; u < NUNIT; u += F.G) hgrn_step3_unit(F, u);
        if (BOTH(4)) GRID_BAR(4);
    }

    if (IN(5)) {
        pg8::Gemm g{F.MIX, F.WoutT, M, DM, DM}; pg8::StaticOrder S; S.init(M, DM, F.G, (int)blockIdx.x);
        pg8::EpiResF32 E{F.x, F.out, DM};
        pg8::gemm_phase<pg8::EpiResF32, pg8::StaticOrder, false, PG8_SP2>(F.lds + RING_OFF, g, S, E);
        if (BOTH(5)) GRID_BAR(5);
    }
    if (IN(6)) {
        const int gw = blockIdx.x * NWAVES + F.wave, NGW = F.G * NWAVES;
        for (int m = gw; m < M; m += NGW) {
            GAS f32x4* xr = (GAS f32x4*)(F.out + (size_t)m * DM) + F.lane; const GAS f32x4* gr = (const GAS f32x4*)F.fin_gain + F.lane;
            f32x4 v[4]; float s2 = 0.f;
#pragma unroll
            for (int j = 0; j < 4; ++j) { v[j] = xr[64 * j]; s2 += (v[j].x * v[j].x + v[j].y * v[j].y) + (v[j].z * v[j].z + v[j].w * v[j].w); }
            const float rstd = 1.f / sqrtf(wave_sum(s2) * (1.f / DM) + EPS);
#pragma unroll
            for (int j = 0; j < 4; ++j) xr[64 * j] = v[j] * rstd * gr[64 * j];
        }
    }
#undef IN
#undef BOTH
}

extern "C" void kernel_launch(void* const* d_in, const int* in_sizes, int n_in, void* d_out, int out_size, void* d_ws, size_t ws_size, hipStream_t stream) {
    static int grid = 0;
    if (grid == 0) {
        if (n_in != 9 || in_sizes[0] != M * DM || out_size != M * DM || ws_size < WS_END) { fprintf(stderr, "kernel_launch: unexpected shapes (n_in %d, in0 %d, out %d, ws %zu); nothing launched\n", n_in, n_in > 0 ? in_sizes[0] : -1, out_size, ws_size); grid = -1; return; }
        int dev = 0, cus = 0, per_cu = 0;
        if (hipGetDevice(&dev) != hipSuccess || hipDeviceGetAttribute(&cus, hipDeviceAttributeMultiprocessorCount, dev) != hipSuccess) { fprintf(stderr, "kernel_launch: device query failed\n"); grid = -1; return; }
        if (hipFuncSetAttribute((const void*)hybrid_fwd, hipFuncAttributeMaxDynamicSharedMemorySize, LDS_BYTES) != hipSuccess) { fprintf(stderr, "kernel_launch: hipFuncSetAttribute failed\n"); grid = -1; return; }
        if (hipOccupancyMaxActiveBlocksPerMultiprocessor(&per_cu, (const void*)hybrid_fwd, NWAVES * 64, LDS_BYTES) != hipSuccess || per_cu < 1)
            fprintf(stderr, "kernel_launch: note: occupancy query reports %d workgroups per CU\n", per_cu);
        (void)hipGetLastError();
        grid = cus;
        if (grid != 256) fprintf(stderr, "kernel_launch: launching %d workgroups; the fused output phase needs exactly 256\n", grid);
    }
    if (grid < 0) return;
    if (hipMemsetAsync((char*)d_ws + WS_CTL, 0, CTL_ZERO_BYTES, stream) != hipSuccess) { fprintf(stderr, "kernel_launch: hipMemsetAsync failed\n"); return; }
    Args a{};
    for (int i = 0; i < 9; ++i) a.in[i] = (const float*)d_in[i];
    a.out = (float*)d_out; a.ws = (unsigned char*)d_ws;
    for (int li = 0; li < N_LAUNCHES; ++li) {
        a.ph_lo = (N_LAUNCHES == PER_PHASE) ? li : 0; a.ph_hi = (N_LAUNCHES == PER_PHASE) ? li + 1 : PER_PHASE; a.li = li;
        hipLaunchKernelGGL(hybrid_fwd, dim3(grid), dim3(NWAVES * 64), LDS_BYTES, stream, a);
        const hipError_t le = hipPeekAtLastError();
        if (le != hipSuccess) { fprintf(stderr, "kernel_launch: launch %d failed: %s\n", li, hipGetErrorName(le)); break; }
    }
}
```
